# Optimizing an MI355X kernel written in HIP

```python
import math
import jax, jax.numpy as jnp
from jax import lax
import numpy as np

D_MODEL = 1024
BATCH = 2
SEQ = 8192
DEPTH = 2

MEM_LEN = 256
HEAD_DIM = 64
N_MIX_HEADS = D_MODEL // HEAD_DIM
N_MEM_HEADS = 4
N_TOK_HEADS = N_MIX_HEADS - N_MEM_HEADS
TOK_WIDTH = N_TOK_HEADS * HEAD_DIM
MEM_WIDTH = N_MEM_HEADS * HEAD_DIM
MIX_WIDTH = TOK_WIDTH + MEM_WIDTH
Q_LORA = 384
KV_LORA = 256
QK_NOPE = 64
QK_ROPE = 32
V_DIM = HEAD_DIM
QK_DIM = QK_NOPE + QK_ROPE
ROPE_THETA = 10000.0
Q_BLOCK = 128
CONV_W = 4
LRU_C = 8.0
N_LRU_BLOCKS = N_TOK_HEADS
LRU_BLOCK = TOK_WIDTH // N_LRU_BLOCKS
ALPHA = (2.0 * DEPTH) ** 0.25
BETA = (8.0 * DEPTH) ** -0.25
NORM_EPS = 1e-6
N_MLA = (DEPTH + 1) // 2
N_LRU = DEPTH // 2
MLA_IN = Q_LORA + KV_LORA + QK_ROPE + MIX_WIDTH + MEM_WIDTH
LRU_IN = TOK_WIDTH + MIX_WIDTH + MEM_WIDTH

kernel_name = "hybrid_mla_rglru_memory_deepnorm"


def _split(t, sizes):
    idx = np.cumsum(sizes)[:-1].tolist()
    return jnp.split(t, idx, axis=-1)


def rms_norm(t, g):
    t32 = t.astype(jnp.float32)
    t32 = t32 * lax.rsqrt(jnp.mean(t32 * t32, axis=-1, keepdims=True) + NORM_EPS)
    return (t32 * g.astype(jnp.float32)).astype(t.dtype)


def layer_norm(t, g, b):
    t32 = t.astype(jnp.float32)
    mu = jnp.mean(t32, axis=-1, keepdims=True)
    var = jnp.mean(jnp.square(t32 - mu), axis=-1, keepdims=True)
    y = (t32 - mu) * lax.rsqrt(var + NORM_EPS)
    return (y * g.astype(jnp.float32) + b.astype(jnp.float32)).astype(t.dtype)


def apply_rope(t, positions):
    half = t.shape[-1] // 2
    inv_freq = ROPE_THETA ** (-jnp.arange(half, dtype=jnp.float32) / half)
    ang = positions.astype(jnp.float32)[..., None] * inv_freq
    cos = jnp.cos(ang)[:, :, None, :].astype(t.dtype)
    sin = jnp.sin(ang)[:, :, None, :].astype(t.dtype)
    t1, t2 = t[..., :half], t[..., half:]
    return jnp.concatenate([t1 * cos - t2 * sin, t1 * sin + t2 * cos], axis=-1)


def causal_attention(q, k, v):
    b, s, h, d = q.shape
    nb = s // Q_BLOCK
    scale = 1.0 / math.sqrt(d)
    qb = q.reshape(b, nb, Q_BLOCK, h, d).transpose(1, 0, 2, 3, 4)
    k_pos = jnp.arange(s)

    def one_block(args):
        q_blk, blk = args
        sc = jnp.einsum('bqhd,bkhd->bhqk', q_blk, k,
                        preferred_element_type=jnp.float32) * scale
        q_pos = blk * Q_BLOCK + jnp.arange(Q_BLOCK)
        mask = k_pos[None, :] <= q_pos[:, None]
        sc = jnp.where(mask[None, None], sc, -jnp.inf)
        p = jax.nn.softmax(sc, axis=-1).astype(v.dtype)
        return jnp.einsum('bhqk,bkhd->bqhd', p, v)

    out = lax.map(one_block, (qb, jnp.arange(nb)))
    return out.transpose(1, 0, 2, 3, 4).reshape(b, s, h, v.shape[-1])


def memory_attention(q, mem_k, mem_v):
    sc = jnp.einsum('bshd,bmhd->bhsm', q, mem_k,
                    preferred_element_type=jnp.float32) / math.sqrt(HEAD_DIM)
    p = jax.nn.softmax(sc, axis=-1).astype(mem_v.dtype)
    return jnp.einsum('bhsm,bmhd->bshd', p, mem_v)


def _lin_rec_combine(left, right):
    a1, b1 = left
    a2, b2 = right
    return a1 * a2, a2 * b1 + b2


def rg_lru_branch(u, conv_w, conv_b, w_r, b_r, w_i, b_i, lam):
    b, s, w = u.shape
    u_pad = jnp.pad(u, ((0, 0), (CONV_W - 1, 0), (0, 0)))
    xc = conv_b + u_pad[:, 0:s] * conv_w[0]
    for tap in range(1, CONV_W):
        xc = xc + u_pad[:, tap:tap + s] * conv_w[tap]
    xb = xc.reshape(b, s, N_LRU_BLOCKS, LRU_BLOCK)
    r = jax.nn.sigmoid(jnp.einsum('bsgi,gij->bsgj', xb, w_r).reshape(b, s, w) + b_r)
    i = jax.nn.sigmoid(jnp.einsum('bsgi,gij->bsgj', xb, w_i).reshape(b, s, w) + b_i)
    log_a = (-LRU_C * jax.nn.softplus(-lam.astype(jnp.float32))) * r.astype(jnp.float32)
    a = jnp.exp(log_a)
    gated_x = jnp.sqrt(-jnp.expm1(2.0 * log_a)) * (i * xc).astype(jnp.float32)
    _, hs = lax.associative_scan(_lin_rec_combine, (a, gated_x), axis=1)
    return hs.astype(u.dtype)


def setup_inputs(seed: int = 0) -> dict:
    key = jax.random.key(seed)
    ks = jax.random.split(key, 24)
    f32 = jnp.float32
    nrm = lambda k, shape, s: jax.random.normal(k, shape, f32) * s
    x = nrm(ks[0], (BATCH, SEQ, D_MODEL), 1.0)
    mem = nrm(ks[1], (BATCH, MEM_LEN, D_MODEL), 1.0)
    offset = jax.random.randint(ks[2], (BATCH, 1), 0, 4096, dtype=jnp.int32)
    positions = (offset + jnp.arange(SEQ, dtype=jnp.int32)[None, :]).astype(jnp.int32)
    mla_w_in = nrm(ks[3], (N_MLA, D_MODEL, MLA_IN), D_MODEL ** -0.5)
    mla_q_norm = 1.0 + nrm(ks[4], (N_MLA, Q_LORA), 0.01)
    mla_w_uq = nrm(ks[5], (N_MLA, Q_LORA, N_TOK_HEADS * QK_DIM), Q_LORA ** -0.5)
    mla_kv_norm = 1.0 + nrm(ks[6], (N_MLA, KV_LORA), 0.01)
    mla_w_ukv = nrm(ks[7], (N_MLA, KV_LORA, N_TOK_HEADS * (QK_NOPE + V_DIM)), KV_LORA ** -0.5)
    lru_w_in = nrm(ks[8], (N_LRU, D_MODEL, LRU_IN), D_MODEL ** -0.5)
    lru_conv_w = nrm(ks[9], (N_LRU, CONV_W, TOK_WIDTH), CONV_W ** -0.5)
    lru_conv_b = nrm(ks[10], (N_LRU, TOK_WIDTH), 0.01)
    lru_w_rgate = nrm(ks[11], (N_LRU, N_LRU_BLOCKS, LRU_BLOCK, LRU_BLOCK), LRU_BLOCK ** -0.5)
    lru_b_rgate = nrm(ks[12], (N_LRU, TOK_WIDTH), 0.01)
    lru_w_igate = nrm(ks[13], (N_LRU, N_LRU_BLOCKS, LRU_BLOCK, LRU_BLOCK), LRU_BLOCK ** -0.5)
    lru_b_igate = nrm(ks[14], (N_LRU, TOK_WIDTH), 0.01)
    a_c = jax.random.uniform(ks[15], (N_LRU, TOK_WIDTH), f32, 0.9, 0.999)
    a0 = a_c ** (1.0 / LRU_C)
    lru_lambda = jnp.log(a0) - jnp.log1p(-a0)
    w_mem_kv = nrm(ks[16], (DEPTH, D_MODEL, 2 * MEM_WIDTH), D_MODEL ** -0.5)
    w_out = nrm(ks[17], (DEPTH, MIX_WIDTH, D_MODEL), BETA * MIX_WIDTH ** -0.5)
    ln_g = 1.0 + nrm(ks[18], (DEPTH, D_MODEL), 0.01)
    ln_b = nrm(ks[19], (DEPTH, D_MODEL), 0.01)
    return {"x": x, "mem": mem, "positions": positions,
            "mla_w_in": mla_w_in, "mla_q_norm": mla_q_norm, "mla_w_uq": mla_w_uq,
            "mla_kv_norm": mla_kv_norm, "mla_w_ukv": mla_w_ukv,
            "lru_w_in": lru_w_in, "lru_conv_w": lru_conv_w, "lru_conv_b": lru_conv_b,
            "lru_w_rgate": lru_w_rgate, "lru_b_rgate": lru_b_rgate,
            "lru_w_igate": lru_w_igate, "lru_b_igate": lru_b_igate, "lru_lambda": lru_lambda,
            "w_mem_kv": w_mem_kv, "w_out": w_out, "ln_g": ln_g, "ln_b": ln_b}


def reference(x, mem, positions, mla_w_in, mla_q_norm, mla_w_uq, mla_kv_norm, mla_w_ukv,
              lru_w_in, lru_conv_w, lru_conv_b, lru_w_rgate, lru_b_rgate,
              lru_w_igate, lru_b_igate, lru_lambda, w_mem_kv, w_out, ln_g, ln_b):
    b, s, _ = x.shape
    h = x
    for layer in range(DEPTH):
        j = layer // 2
        if layer % 2 == 0:
            z = h @ mla_w_in[j]
            c_q, c_kv, k_r, gate, q_mem = _split(
                z, [Q_LORA, KV_LORA, QK_ROPE, MIX_WIDTH, MEM_WIDTH])
            q = (rms_norm(c_q, mla_q_norm[j]) @ mla_w_uq[j]).reshape(b, s, N_TOK_HEADS, QK_DIM)
            q = jnp.concatenate([q[..., :QK_NOPE], apply_rope(q[..., QK_NOPE:], positions)], axis=-1)
            kv = (rms_norm(c_kv, mla_kv_norm[j]) @ mla_w_ukv[j]).reshape(
                b, s, N_TOK_HEADS, QK_NOPE + V_DIM)
            k_nope, v = kv[..., :QK_NOPE], kv[..., QK_NOPE:]
            k_rope = apply_rope(k_r[:, :, None, :], positions)
            k = jnp.concatenate(
                [k_nope, jnp.broadcast_to(k_rope, (b, s, N_TOK_HEADS, QK_ROPE))], axis=-1)
            tok = causal_attention(q, k, v).reshape(b, s, TOK_WIDTH)
        else:
            z = h @ lru_w_in[j]
            u, gate, q_mem = _split(z, [TOK_WIDTH, MIX_WIDTH, MEM_WIDTH])
            tok = rg_lru_branch(u, lru_conv_w[j], lru_conv_b[j], lru_w_rgate[j], lru_b_rgate[j],
                                lru_w_igate[j], lru_b_igate[j], lru_lambda[j])
        mem_kv = (mem @ w_mem_kv[layer]).reshape(b, MEM_LEN, 2, N_MEM_HEADS, HEAD_DIM)
        mem_out = memory_attention(q_mem.reshape(b, s, N_MEM_HEADS, HEAD_DIM),
                                   mem_kv[:, :, 0], mem_kv[:, :, 1]).reshape(b, s, MEM_WIDTH)
        y = jnp.concatenate([tok, mem_out], axis=-1) * jax.nn.silu(gate)
        h = layer_norm(ALPHA * h + y @ w_out[layer], ln_g[layer], ln_b[layer])
    return h
```

```cpp
#include <hip/hip_runtime.h>
#include <cstdio>
#include <cstdint>

typedef unsigned short bf16;
typedef short bf16x8 __attribute__((ext_vector_type(8)));
typedef float f32x4 __attribute__((ext_vector_type(4)));
typedef unsigned short u16x4 __attribute__((ext_vector_type(4)));

constexpr int BATCH = 2, SEQ = 8192, DM = 1024, M = BATCH * SEQ;
constexpr int MEML = 256, NTH = 12, NMH = 4, TOKW = 768, MEMW = 256;
constexpr int QL = 384, KVL = 256, QKD = 96;
constexpr int MLA_IN = 1952, LRU_IN = 2048;
constexpr int QP = NTH * QKD;
constexpr float NORM_EPS = 1e-6f;
constexpr float ALPHA = 1.41421356237309515f;
constexpr float LOG2E = 1.4426950408889634f;
constexpr float C2Q = LOG2E * 0.10206207261596575f;
constexpr float C2M = LOG2E * 0.125f;

constexpr size_t MiB = 1u << 20;
constexpr size_t WS_CTL = 0;
constexpr size_t WS_TAB = 1 * MiB;
constexpr size_t WS_RINVQ = 3 * MiB;
constexpr size_t WS_RINVKV = 3 * MiB + 65536;
constexpr size_t WS_KR = 4 * MiB;
constexpr size_t WS_MKV = 6 * MiB;
constexpr size_t WS_MEMB = 7 * MiB;
constexpr size_t WS_W0T = 8 * MiB;
constexpr size_t WS_WQT = 12 * MiB;
constexpr size_t WS_WKVT = 13 * MiB;
constexpr size_t WS_W1T = 14 * MiB;
constexpr size_t WS_WMT = 18 * MiB;
constexpr size_t WS_WOT = 20 * MiB;
constexpr size_t WS_XB = 24 * MiB;
constexpr size_t WS_CQ = 56 * MiB;
constexpr size_t WS_CKV = 68 * MiB;
constexpr size_t WS_Q = 76 * MiB;
constexpr size_t WS_K = 112 * MiB;
constexpr size_t WS_V = 148 * MiB;
constexpr size_t WS_G = 176 * MiB;
constexpr size_t WS_QM = 208 * MiB;
constexpr size_t WS_Y = 216 * MiB;
constexpr size_t WS_END = 248 * MiB;
constexpr size_t WS_U = 56 * MiB;
constexpr size_t WS_LA = 80 * MiB;
constexpr size_t WS_GX = 128 * MiB;

__device__ __forceinline__ unsigned f2bf(float f) { unsigned u = __builtin_bit_cast(unsigned, f); return (u + 0x7fffu + ((u >> 16) & 1u)) >> 16; }
__device__ __forceinline__ float bf2f(bf16 h) { return __builtin_bit_cast(float, (unsigned)h << 16); }
__device__ __forceinline__ float silu_f(float v) { return v / (1.f + __expf(-v)); }
__device__ __forceinline__ float sigmoid_f(float v) { return 1.f / (1.f + __expf(-v)); }
__device__ __forceinline__ void st4bf(bf16* p, f32x4 v) { u16x4 o; o.x = (bf16)f2bf(v[0]); o.y = (bf16)f2bf(v[1]); o.z = (bf16)f2bf(v[2]); o.w = (bf16)f2bf(v[3]); *(u16x4*)p = o; }

__device__ __forceinline__ int w0_srccol(int n) {
    if (n < 384) return n;
    if (n < 416) return 640 + (n - 384);
    if (n < 512) return -1;
    if (n < 768) return 384 + (n - 512);
    if (n < 1792) return 672 + (n - 768);
    return 1696 + (n - 1792);
}
__global__ void k_prep_wt(const float* __restrict__ src, int K, int Nsrc, bf16* __restrict__ dst, int Ndst, int mode, const float* __restrict__ kscale) {
    const size_t idx = (size_t)blockIdx.x * blockDim.x + threadIdx.x;
    if (idx >= (size_t)Ndst * K) return;
    const int n = (int)(idx / K), k = (int)(idx % K);
    int sc = (mode == 1) ? w0_srccol(n) : (n < Nsrc ? n : -1);
    float v = 0.f;
    if (sc >= 0) { v = src[(size_t)k * Nsrc + sc]; if (kscale) v *= kscale[k]; }
    dst[idx] = (bf16)f2bf(v);
}
__global__ void k_cvt_bf16(const float* __restrict__ src, bf16* __restrict__ dst, size_t n4) {
    const size_t i = (size_t)blockIdx.x * blockDim.x + threadIdx.x;
    if (i >= n4) return;
    f32x4 v = ((const f32x4*)src)[i];
    st4bf(dst + 4 * i, v);
}
__global__ void k_rope_tab(const int* __restrict__ pos, float2* __restrict__ tab) {
    const int idx = blockIdx.x * blockDim.x + threadIdx.x;
    if (idx >= M * 16) return;
    const int row = idx >> 4, i = idx & 15;
    const float inv_freq = (float)exp2(-(double)i / 16.0 * 13.287712379549449);
    const float angf = (float)pos[row] * inv_freq;
    double t = (double)angf * 0.15915494309189535;
    t -= rint(t);
    const double r = t * 6.283185307179586, r2 = r * r;
    double s = 0.0, c = 0.0;
    double ts = r, tc = 1.0;
#pragma unroll 1
    for (int n = 0; n < 16; ++n) { c += tc; s += ts; tc = -tc * r2 / (double)((2 * n + 1) * (2 * n + 2)); ts = -ts * r2 / (double)((2 * n + 2) * (2 * n + 3)); }
    tab[idx] = make_float2((float)c, (float)s);
}

template <class Epi>
__global__ __launch_bounds__(256) void k_gemm(const bf16* __restrict__ A, const bf16* __restrict__ Bt, int K, Epi epi) {
    const int lane = threadIdx.x & 63, w = threadIdx.x >> 6;
    const int m0 = blockIdx.y * 128 + w * 32, n0 = blockIdx.x * 64;
    const int fr = lane & 15, fq = lane >> 4;
    f32x4 acc[2][4];
#pragma unroll
    for (int a = 0; a < 2; ++a)
#pragma unroll
        for (int b = 0; b < 4; ++b) acc[a][b] = (f32x4){0.f, 0.f, 0.f, 0.f};
    const bf16* ap = A + (size_t)(m0 + fr) * K + fq * 8;
    const bf16* bp = Bt + (size_t)(n0 + fr) * K + fq * 8;
    for (int k0 = 0; k0 < K; k0 += 32) {
        bf16x8 a[2], b[4];
#pragma unroll
        for (int mi = 0; mi < 2; ++mi) a[mi] = *(const bf16x8*)(ap + (size_t)mi * 16 * K + k0);
#pragma unroll
        for (int ni = 0; ni < 4; ++ni) b[ni] = *(const bf16x8*)(bp + (size_t)ni * 16 * K + k0);
#pragma unroll
        for (int mi = 0; mi < 2; ++mi)
#pragma unroll
            for (int ni = 0; ni < 4; ++ni) acc[mi][ni] = __builtin_amdgcn_mfma_f32_16x16x32_bf16(b[ni], a[mi], acc[mi][ni], 0, 0, 0);
    }
    epi(acc, m0, n0, fr, fq);
}

struct EpiZ0 {
    bf16* CQ; bf16* CKV; float* KR; bf16* G; bf16* QM;
    __device__ void operator()(f32x4 (&acc)[2][4], int m0, int n0, int fr, int fq) const {
#pragma unroll
        for (int mi = 0; mi < 2; ++mi) { const size_t row = m0 + 16 * mi + fr;
#pragma unroll
            for (int ni = 0; ni < 4; ++ni) { const int col = n0 + 16 * ni + 4 * fq; f32x4 v = acc[mi][ni];
                if (col < 384) st4bf(CQ + row * QL + col, v);
                else if (col < 416) *(f32x4*)(KR + row * 32 + (col - 384)) = v;
                else if (col < 512) {}
                else if (col < 768) st4bf(CKV + row * KVL + (col - 512), v);
                else if (col < 1792) { f32x4 s = {silu_f(v[0]), silu_f(v[1]), silu_f(v[2]), silu_f(v[3])}; st4bf(G + row * DM + (col - 768), s); }
                else st4bf(QM + row * MEMW + (col - 1792), v * C2M); } }
    }
};
struct EpiZ1 {
    bf16* U; bf16* G; bf16* QM;
    __device__ void operator()(f32x4 (&acc)[2][4], int m0, int n0, int fr, int fq) const {
#pragma unroll
        for (int mi = 0; mi < 2; ++mi) { const size_t row = m0 + 16 * mi + fr;
#pragma unroll
            for (int ni = 0; ni < 4; ++ni) { const int col = n0 + 16 * ni + 4 * fq; f32x4 v = acc[mi][ni];
                if (col < 768) st4bf(U + row * TOKW + col, v);
                else if (col < 1792) { f32x4 s = {silu_f(v[0]), silu_f(v[1]), silu_f(v[2]), silu_f(v[3])}; st4bf(G + row * DM + (col - 768), s); }
                else st4bf(QM + row * MEMW + (col - 1792), v * C2M); } }
    }
};
struct EpiQ {
    bf16* Q; const float* rinv; const float2* tab;
    __device__ void operator()(f32x4 (&acc)[2][4], int m0, int n0, int fr, int fq) const {
#pragma unroll
        for (int mi = 0; mi < 2; ++mi) { const size_t row = m0 + 16 * mi + fr; const float sc = rinv[row] * C2Q;
#pragma unroll
            for (int ni = 0; ni < 4; ++ni) acc[mi][ni] = acc[mi][ni] * sc;
#pragma unroll
            for (int ni = 0; ni < 4; ni += 2) { const int c16 = n0 + 16 * ni;
                if (c16 >= 64 && (c16 - 64) % QKD == 0) {
#pragma unroll
                    for (int r = 0; r < 4; ++r) { const float2 cs = tab[row * 16 + 4 * fq + r]; const float t1 = acc[mi][ni][r], t2 = acc[mi][ni + 1][r];
                        acc[mi][ni][r] = t1 * cs.x - t2 * cs.y; acc[mi][ni + 1][r] = t1 * cs.y + t2 * cs.x; } } }
#pragma unroll
            for (int ni = 0; ni < 4; ++ni) { const int col = n0 + 16 * ni + 4 * fq; if (col < QP) st4bf(Q + row * QP + col, acc[mi][ni]); } }
    }
};
struct EpiKV {
    bf16* Kb; bf16* Vb; const float* rinv;
    __device__ void operator()(f32x4 (&acc)[2][4], int m0, int n0, int fr, int fq) const {
#pragma unroll
        for (int mi = 0; mi < 2; ++mi) { const size_t row = m0 + 16 * mi + fr; const float sc = rinv[row];
#pragma unroll
            for (int ni = 0; ni < 4; ++ni) { const int col = n0 + 16 * ni + 4 * fq; const int h = col >> 7, c = col & 127; f32x4 v = acc[mi][ni] * sc;
                if (c < 64) st4bf(Kb + row * QP + h * QKD + c, v); else st4bf(Vb + row * TOKW + h * 64 + (c - 64), v); } }
    }
};
struct EpiMem {
    bf16* MK; bf16* MV;
    __device__ void operator()(f32x4 (&acc)[2][4], int m0, int n0, int fr, int fq) const {
#pragma unroll
        for (int mi = 0; mi < 2; ++mi) { const size_t row = m0 + 16 * mi + fr;
#pragma unroll
            for (int ni = 0; ni < 4; ++ni) { const int col = n0 + 16 * ni + 4 * fq;
                if (col < 256) st4bf(MK + row * 256 + col, acc[mi][ni]); else st4bf(MV + row * 256 + (col - 256), acc[mi][ni]); } }
    }
};
struct EpiOut {
    const float* base; float* T;
    __device__ void operator()(f32x4 (&acc)[2][4], int m0, int n0, int fr, int fq) const {
#pragma unroll
        for (int mi = 0; mi < 2; ++mi) { const size_t row = m0 + 16 * mi + fr;
#pragma unroll
            for (int ni = 0; ni < 4; ++ni) { const int col = n0 + 16 * ni + 4 * fq; const f32x4 b = *(const f32x4*)(base + row * DM + col); *(f32x4*)(T + row * DM + col) = b * ALPHA + acc[mi][ni]; } }
    }
};

__device__ __forceinline__ float wave_sum(float v) {
#pragma unroll
    for (int o = 1; o < 64; o <<= 1) v += __shfl_xor(v, o);
    return v;
}
__global__ void k_rinv(const bf16* __restrict__ X, int W, float* __restrict__ rinv) {
    const int row = blockIdx.x * (blockDim.x >> 6) + (threadIdx.x >> 6), lane = threadIdx.x & 63;
    float s = 0.f;
    for (int c = lane; c < W; c += 64) { const float v = bf2f(X[(size_t)row * W + c]); s += v * v; }
    s = wave_sum(s);
    if (lane == 0) rinv[row] = 1.0f / sqrtf(s / (float)W + NORM_EPS);
}
__global__ void k_krope(const float* __restrict__ KR, const float2* __restrict__ tab, bf16* __restrict__ Kb) {
    const int idx = blockIdx.x * blockDim.x + threadIdx.x;
    if (idx >= M * 16) return;
    const size_t row = idx >> 4; const int i = idx & 15;
    const float t1 = KR[row * 32 + i], t2 = KR[row * 32 + 16 + i]; const float2 cs = tab[idx];
    const bf16 o1 = (bf16)f2bf(t1 * cs.x - t2 * cs.y), o2 = (bf16)f2bf(t1 * cs.y + t2 * cs.x);
    for (int h = 0; h < NTH; ++h) { Kb[row * QP + h * QKD + 64 + i] = o1; Kb[row * QP + h * QKD + 80 + i] = o2; }
}
__global__ void k_ln(float* __restrict__ T, const float* __restrict__ g, const float* __restrict__ b, bf16* __restrict__ XBo) {
    const int row = blockIdx.x * (blockDim.x >> 6) + (threadIdx.x >> 6), lane = threadIdx.x & 63;
    f32x4* tr = (f32x4*)(T + (size_t)row * DM) + lane;
    f32x4 v[4]; float s = 0.f;
#pragma unroll
    for (int j = 0; j < 4; ++j) { v[j] = tr[64 * j]; s += (v[j][0] + v[j][1]) + (v[j][2] + v[j][3]); }
    const float mean = wave_sum(s) * (1.f / DM); float s2 = 0.f;
#pragma unroll
    for (int j = 0; j < 4; ++j) { v[j] = v[j] - mean; s2 += (v[j][0] * v[j][0] + v[j][1] * v[j][1]) + (v[j][2] * v[j][2] + v[j][3] * v[j][3]); }
    const float rstd = 1.0f / sqrtf(wave_sum(s2) * (1.f / DM) + NORM_EPS);
#pragma unroll
    for (int j = 0; j < 4; ++j) { const int c = 4 * lane + 256 * j; const f32x4 gg = *(const f32x4*)(g + c), bb = *(const f32x4*)(b + c);
        const f32x4 o = v[j] * rstd * gg + bb; tr[64 * j] = o; if (XBo) st4bf(XBo + (size_t)row * DM + c, o); }
}

template <int DQK, bool CAUSAL>
__global__ __launch_bounds__(64) void k_attn(const bf16* __restrict__ Q, int qpitch, const bf16* __restrict__ Kb, int kpitch, const bf16* __restrict__ Vb, int vpitch,
                                             int nkrows, const bf16* __restrict__ G, bf16* __restrict__ Y, int ycol0) {
    const int lane = threadIdx.x, qi = blockIdx.x * 64 + lane, h = blockIdx.y, b = blockIdx.z;
    const size_t row = (size_t)b * SEQ + qi;
    float q[DQK];
#pragma unroll
    for (int d = 0; d < DQK; d += 8) { const bf16x8 t = *(const bf16x8*)(Q + row * qpitch + h * DQK + d);
#pragma unroll
        for (int j = 0; j < 8; ++j) q[d + j] = bf2f((bf16)t[j]); }
    float o[64];
#pragma unroll
    for (int d = 0; d < 64; ++d) o[d] = 0.f;
    float m = -1e30f, l = 0.f;
    const int kend = CAUSAL ? (blockIdx.x * 64 + 64) : nkrows;
    const bf16* kp = Kb + (size_t)b * nkrows * kpitch + h * DQK;
    const bf16* vp = Vb + (size_t)b * nkrows * vpitch + h * 64;
    for (int k = 0; k < kend; ++k) {
        float s = 0.f;
#pragma unroll
        for (int d = 0; d < DQK; d += 8) { const bf16x8 t = *(const bf16x8*)(kp + (size_t)k * kpitch + d);
#pragma unroll
            for (int j = 0; j < 8; ++j) s += q[d + j] * bf2f((bf16)t[j]); }
        if (CAUSAL && k > qi) s = -1e30f;
        const float mn = fmaxf(m, s), f = exp2f(m - mn), p = (CAUSAL && k > qi) ? 0.f : exp2f(s - mn);
        l = l * f + p; m = mn;
#pragma unroll
        for (int d = 0; d < 64; d += 8) { const bf16x8 t = *(const bf16x8*)(vp + (size_t)k * vpitch + d);
#pragma unroll
            for (int j = 0; j < 8; ++j) o[d + j] = o[d + j] * f + p * bf2f((bf16)t[j]); }
    }
    const float rl = 1.f / l;
#pragma unroll
    for (int d = 0; d < 64; d += 4) { const size_t off = row * DM + ycol0 + h * 64 + d; const u16x4 gg = *(const u16x4*)(G + off);
        f32x4 v = {o[d] * rl * bf2f(gg.x), o[d + 1] * rl * bf2f(gg.y), o[d + 2] * rl * bf2f(gg.z), o[d + 3] * rl * bf2f(gg.w)}; st4bf(Y + off, v); }
}

__global__ void k_lru_gates(const bf16* __restrict__ U, const float* __restrict__ cw, const float* __restrict__ cb, const float* __restrict__ Wr, const float* __restrict__ br,
                            const float* __restrict__ Wi, const float* __restrict__ bi, const float* __restrict__ lam, float* __restrict__ LA, float* __restrict__ GX) {
    const size_t idx = (size_t)blockIdx.x * blockDim.x + threadIdx.x;
    if (idx >= (size_t)M * TOKW) return;
    const size_t row = idx / TOKW; const int c = (int)(idx % TOKW), g = c >> 6, j = c & 63, t = (int)(row % SEQ);
    float rp = br[c], ip = bi[c], xcj = 0.f;
    for (int i = 0; i < 64; ++i) { const int ci = g * 64 + i; float xc = cb[ci];
#pragma unroll
        for (int tap = 0; tap < 4; ++tap) { const int tt = t + tap - 3; if (tt >= 0) xc += bf2f(U[(row + tap - 3) * TOKW + ci]) * cw[tap * TOKW + ci]; }
        rp += xc * Wr[(g * 64 + i) * 64 + j]; ip += xc * Wi[(g * 64 + i) * 64 + j]; if (i == j) xcj = xc; }
    const float r = sigmoid_f(rp), ig = sigmoid_f(ip);
    const float sp = log1pf(expf(-lam[c]));
    const float la = -8.0f * sp * r;
    LA[idx] = la; GX[idx] = sqrtf(-expm1f(2.0f * la)) * (ig * xcj);
}
__global__ void k_lru_scan(const float* __restrict__ LA, const float* __restrict__ GX, const bf16* __restrict__ G, bf16* __restrict__ Y) {
    const int idx = blockIdx.x * blockDim.x + threadIdx.x;
    if (idx >= BATCH * TOKW) return;
    const int b = idx / TOKW, c = idx % TOKW;
    float h = 0.f;
    for (int t = 0; t < SEQ; ++t) { const size_t row = (size_t)b * SEQ + t; h = expf(LA[row * TOKW + c]) * h + GX[row * TOKW + c]; Y[row * DM + c] = (bf16)f2bf(h * bf2f(G[row * DM + c])); }
}

extern "C" void kernel_launch(void* const* d_in, const int* in_sizes, int n_in, void* d_out, int out_size, void* d_ws, size_t ws_size, hipStream_t stream) {
    if (n_in != 20 || out_size != M * DM || ws_size < WS_END) { fprintf(stderr, "kernel_launch: unexpected shapes (n_in %d out %d ws %zu)\n", n_in, out_size, ws_size); return; }
    const float* x = (const float*)d_in[0]; const float* mem = (const float*)d_in[1]; const int* pos = (const int*)d_in[2];
    const float* mla_w_in = (const float*)d_in[3]; const float* mla_q_norm = (const float*)d_in[4]; const float* mla_w_uq = (const float*)d_in[5];
    const float* mla_kv_norm = (const float*)d_in[6]; const float* mla_w_ukv = (const float*)d_in[7]; const float* lru_w_in = (const float*)d_in[8];
    const float* conv_w = (const float*)d_in[9]; const float* conv_b = (const float*)d_in[10]; const float* w_r = (const float*)d_in[11]; const float* b_r = (const float*)d_in[12];
    const float* w_i = (const float*)d_in[13]; const float* b_i = (const float*)d_in[14]; const float* lam = (const float*)d_in[15];
    const float* w_mem_kv = (const float*)d_in[16]; const float* w_out = (const float*)d_in[17]; const float* ln_g = (const float*)d_in[18]; const float* ln_b = (const float*)d_in[19];
    float* out = (float*)d_out; unsigned char* ws = (unsigned char*)d_ws;
    float2* TAB = (float2*)(ws + WS_TAB); float* RINVQ = (float*)(ws + WS_RINVQ); float* RINVKV = (float*)(ws + WS_RINVKV); float* KR = (float*)(ws + WS_KR);
    bf16* MKV = (bf16*)(ws + WS_MKV); bf16* MEMB = (bf16*)(ws + WS_MEMB);
    bf16* W0T = (bf16*)(ws + WS_W0T); bf16* WQT = (bf16*)(ws + WS_WQT); bf16* WKVT = (bf16*)(ws + WS_WKVT); bf16* W1T = (bf16*)(ws + WS_W1T);
    bf16* WMT = (bf16*)(ws + WS_WMT); bf16* WOT = (bf16*)(ws + WS_WOT);
    bf16* XB = (bf16*)(ws + WS_XB); bf16* CQ = (bf16*)(ws + WS_CQ); bf16* CKV = (bf16*)(ws + WS_CKV); bf16* Q = (bf16*)(ws + WS_Q); bf16* Kb = (bf16*)(ws + WS_K); bf16* Vb = (bf16*)(ws + WS_V);
    bf16* G = (bf16*)(ws + WS_G); bf16* QM = (bf16*)(ws + WS_QM); bf16* Y = (bf16*)(ws + WS_Y);
    bf16* U = (bf16*)(ws + WS_U); float* LA = (float*)(ws + WS_LA); float* GX = (float*)(ws + WS_GX);
    auto nb = [](size_t n, int t) { return (unsigned)((n + t - 1) / t); };
    k_prep_wt<<<nb((size_t)2048 * 1024, 256), 256, 0, stream>>>(mla_w_in, 1024, MLA_IN, W0T, 2048, 1, nullptr);
    k_prep_wt<<<nb((size_t)1280 * QL, 256), 256, 0, stream>>>(mla_w_uq, QL, QP, WQT, 1280, 0, mla_q_norm);
    k_prep_wt<<<nb((size_t)1536 * KVL, 256), 256, 0, stream>>>(mla_w_ukv, KVL, 1536, WKVT, 1536, 0, mla_kv_norm);
    k_prep_wt<<<nb((size_t)2048 * 1024, 256), 256, 0, stream>>>(lru_w_in, 1024, LRU_IN, W1T, 2048, 0, nullptr);
    for (int l = 0; l < 2; ++l) {
        k_prep_wt<<<nb((size_t)512 * 1024, 256), 256, 0, stream>>>(w_mem_kv + (size_t)l * 1024 * 512, 1024, 512, WMT + (size_t)l * 512 * 1024, 512, 0, nullptr);
        k_prep_wt<<<nb((size_t)1024 * 1024, 256), 256, 0, stream>>>(w_out + (size_t)l * 1024 * 1024, 1024, 1024, WOT + (size_t)l * 1024 * 1024, 1024, 0, nullptr);
    }
    k_cvt_bf16<<<nb((size_t)M * DM / 4, 256), 256, 0, stream>>>(x, XB, (size_t)M * DM / 4);
    k_cvt_bf16<<<nb((size_t)512 * DM / 4, 256), 256, 0, stream>>>(mem, MEMB, (size_t)512 * DM / 4);
    k_rope_tab<<<nb((size_t)M * 16, 256), 256, 0, stream>>>(pos, TAB);
    for (int l = 0; l < 2; ++l) { EpiMem e{MKV + (size_t)l * 2 * 512 * 256, MKV + (size_t)l * 2 * 512 * 256 + 512 * 256};
        k_gemm<EpiMem><<<dim3(512 / 64, 512 / 128), 256, 0, stream>>>(MEMB, WMT + (size_t)l * 512 * 1024, 1024, e); }
    { EpiZ0 e{CQ, CKV, KR, G, QM}; k_gemm<EpiZ0><<<dim3(2048 / 64, M / 128), 256, 0, stream>>>(XB, W0T, 1024, e); }
    k_rinv<<<M / 4, 256, 0, stream>>>(CQ, QL, RINVQ);
    k_rinv<<<M / 4, 256, 0, stream>>>(CKV, KVL, RINVKV);
    k_krope<<<nb((size_t)M * 16, 256), 256, 0, stream>>>(KR, TAB, Kb);
    { EpiQ e{Q, RINVQ, TAB}; k_gemm<EpiQ><<<dim3(1280 / 64, M / 128), 256, 0, stream>>>(CQ, WQT, QL, e); }
    { EpiKV e{Kb, Vb, RINVKV}; k_gemm<EpiKV><<<dim3(1536 / 64, M / 128), 256, 0, stream>>>(CKV, WKVT, KVL, e); }
    k_attn<QKD, true><<<dim3(SEQ / 64, NTH, BATCH), 64, 0, stream>>>(Q, QP, Kb, QP, Vb, TOKW, SEQ, G, Y, 0);
    k_attn<64, false><<<dim3(SEQ / 64, NMH, BATCH), 64, 0, stream>>>(QM, MEMW, MKV, 256, MKV + 512 * 256, 256, MEML, G, Y, TOKW);
    { EpiOut e{x, out}; k_gemm<EpiOut><<<dim3(1024 / 64, M / 128), 256, 0, stream>>>(Y, WOT, 1024, e); }
    k_ln<<<M / 4, 256, 0, stream>>>(out, ln_g, ln_b, XB);
    { EpiZ1 e{U, G, QM}; k_gemm<EpiZ1><<<dim3(2048 / 64, M / 128), 256, 0, stream>>>(XB, W1T, 1024, e); }
    k_lru_gates<<<nb((size_t)M * TOKW, 256), 256, 0, stream>>>(U, conv_w, conv_b, w_r, b_r, w_i, b_i, lam, LA, GX);
    k_lru_scan<<<nb(BATCH * TOKW, 64), 64, 0, stream>>>(LA, GX, G, Y);
    k_attn<64, false><<<dim3(SEQ / 64, NMH, BATCH), 64, 0, stream>>>(QM, MEMW, MKV + (size_t)2 * 512 * 256, 256, MKV + (size_t)2 * 512 * 256 + 512 * 256, 256, MEML, G, Y, TOKW);
    { EpiOut e{out, out}; k_gemm<EpiOut><<<dim3(1024 / 64, M / 128), 256, 0, stream>>>(Y, WOT + (size_t)1024 * 1024, 1024, e); }
    k_ln<<<M / 4, 256, 0, stream>>>(out, ln_g + DM, ln_b + DM, nullptr);
}
```
